# Optimizing an MI355X kernel written in HIP

```python
import math, functools
import jax, jax.numpy as jnp
from jax import lax
import numpy as np

D_MODEL = 1024
BATCH = 4
SEQ = 4096
DEPTH = 1
DEC_BATCH = 32
DEC_SEQ = 32
PAST_LEN = 4096

CHUNK = 64
WINDOW = 128
D_MIX = D_MODEL
ATTN_WIDTH = D_MIX // 2
GLA_WIDTH = D_MIX - ATTN_WIDTH
HEAD_DIM = 64
N_HEADS = ATTN_WIDTH // HEAD_DIM
N_KV_HEADS = 2
GQA_GROUP = N_HEADS // N_KV_HEADS
ROT_DIM = HEAD_DIM // 4
ROPE_THETA = 500000.0
GLA_HEADS = 4
GLA_DV = GLA_WIDTH // GLA_HEADS
GLA_DK = GLA_DV // 2
GLA_RANK = 16
GATE_TAU = 16.0
NORM_EPS = 1e-6
IN_SIZES = (N_HEADS * HEAD_DIM, N_KV_HEADS * HEAD_DIM, N_KV_HEADS * HEAD_DIM, ATTN_WIDTH,
            GLA_HEADS * GLA_DK, GLA_HEADS * GLA_DK, GLA_WIDTH, GLA_WIDTH, GLA_RANK)
D_IN = sum(IN_SIZES)

kernel_name = 'hymba_swa_sink_gla_streaming_step'


def _rms(x, w):
    x32 = x.astype(jnp.float32)
    y = x32 * lax.rsqrt(jnp.mean(x32 * x32, axis=-1, keepdims=True) + NORM_EPS)
    return (y * w.astype(jnp.float32)).astype(x.dtype)


def _rotary(x, pos):
    half = ROT_DIM // 2
    inv = ROPE_THETA ** (-jnp.arange(half, dtype=jnp.float32) * (2.0 / ROT_DIM))
    ang = pos.astype(jnp.float32)[:, None] * inv[None, :]
    cos = jnp.cos(ang)[:, None, :]
    sin = jnp.sin(ang)[:, None, :]
    xf = x.astype(jnp.float32)
    x1 = xf[..., :half]
    x2 = xf[..., half:ROT_DIM]
    out = jnp.concatenate([x1 * cos - x2 * sin, x1 * sin + x2 * cos, xf[..., ROT_DIM:]], axis=-1)
    return out.astype(x.dtype)


def _sink_attend(q, k, v, valid, sinks):
    B, N, Cq = q.shape[:3]
    s = jnp.einsum('bnqkgd,bnskd->bnkgqs', q, k).astype(jnp.float32) * (HEAD_DIM ** -0.5)
    s = jnp.where(valid[None, :, None, None, None, :], s, -1e30)
    sink = sinks.astype(jnp.float32).reshape(1, 1, N_KV_HEADS, GQA_GROUP, 1, 1)
    m = jnp.maximum(jnp.max(s, axis=-1, keepdims=True), sink)
    p = jnp.exp(s - m)
    probs = p / (jnp.sum(p, axis=-1, keepdims=True) + jnp.exp(sink - m))
    o = jnp.einsum('bnkgqs,bnskd->bnqkgd', probs.astype(v.dtype), v)
    return o.reshape(B, N * Cq, N_HEADS * HEAD_DIM)


def _attend_prompt(q, k, v, sinks):
    B, T = q.shape[:2]
    N = T // CHUNK
    nb = WINDOW // CHUNK
    qc = q.reshape(B, N, CHUNK, N_KV_HEADS, GQA_GROUP, HEAD_DIM)

    def band(t):
        tc = t.reshape(B, N, CHUNK, N_KV_HEADS, HEAD_DIM)
        tp = jnp.pad(tc, ((0, 0), (nb, 0), (0, 0), (0, 0), (0, 0)))
        return jnp.concatenate([tp[:, j:j + N] for j in range(nb + 1)], axis=2)

    key_chunk = jnp.arange(N)[:, None] - nb + jnp.arange((nb + 1) * CHUNK)[None, :] // CHUNK
    return _sink_attend(qc, band(k), band(v), key_chunk >= 0, sinks)


def _attend_sample(q, k, v, sinks, cache_k, cache_v):
    B, T = q.shape[:2]
    kk = jnp.concatenate([cache_k.astype(k.dtype), k], axis=1)[:, None]
    vv = jnp.concatenate([cache_v.astype(v.dtype), v], axis=1)[:, None]
    valid = jnp.ones((1, kk.shape[2]), dtype=bool)
    return _sink_attend(q.reshape(B, 1, T, N_KV_HEADS, GQA_GROUP, HEAD_DIM), kk, vv, valid, sinks)


def _gla_chunked(q, k, v, log_a, s0, chunk):
    B, T, H, DK = q.shape
    DV = v.shape[-1]
    N = T // chunk
    f = lambda t: t.astype(jnp.float32).reshape(B, N, chunk, H, t.shape[-1])
    q, k, v, g = f(q) * (GLA_DK ** -0.5), f(k), f(v), f(log_a)
    b = jnp.cumsum(g, axis=2)
    b_last = b[:, :, -1:]
    q_in = q * jnp.exp(b)
    A = jnp.einsum('bnihd,bnjhd->bnhij', q_in, k * jnp.exp(-b))
    causal = jnp.tril(jnp.ones((chunk, chunk), dtype=bool))
    A = jnp.where(causal, A, 0.0)
    o_intra = jnp.einsum('bnhij,bnjhe->bnihe', A, v)
    u = jnp.einsum('bnjhd,bnjhe->bnhde', k * jnp.exp(b_last - b), v)
    decay = jnp.exp(b_last[:, :, 0])

    def step(s, inp):
        dec, uu = inp
        return dec[..., None] * s + uu, s

    s_final, s_prev = lax.scan(step, s0.astype(jnp.float32), (jnp.moveaxis(decay, 1, 0), jnp.moveaxis(u, 1, 0)))
    o_inter = jnp.einsum('bnihd,bnhde->bnihe', q_in, jnp.moveaxis(s_prev, 0, 1))
    return (o_intra + o_inter).reshape(B, T, H, DV), s_final


def _layer(x, pos, attend, s0, gla_chunk, norm_pre_w, w_in, attn_sinks, w_gk_up, b_gk, gla_norm_w, w_out, norm_post_w):
    B, T, _ = x.shape
    h = _rms(x, norm_pre_w)
    z = h @ w_in
    idx = np.cumsum(IN_SIZES)[:-1].tolist()
    aq, ak, av, ag, gq, gk, gv, gg, glr = jnp.split(z, idx, axis=-1)
    aq = _rotary(aq.reshape(B, T, N_HEADS, HEAD_DIM), pos)
    ak = _rotary(ak.reshape(B, T, N_KV_HEADS, HEAD_DIM), pos)
    av = av.reshape(B, T, N_KV_HEADS, HEAD_DIM)
    attn = attend(aq, ak, av, attn_sinks) * jax.nn.silu(ag)
    log_a = jax.nn.log_sigmoid((glr @ w_gk_up + b_gk).astype(jnp.float32)) / GATE_TAU
    o, s_new = _gla_chunked(gq.reshape(B, T, GLA_HEADS, GLA_DK), gk.reshape(B, T, GLA_HEADS, GLA_DK),
                            gv.reshape(B, T, GLA_HEADS, GLA_DV), log_a.reshape(B, T, GLA_HEADS, GLA_DK), s0, gla_chunk)
    o = _rms(o.astype(x.dtype), gla_norm_w).reshape(B, T, GLA_WIDTH) * jax.nn.silu(gg)
    mix = jnp.concatenate([attn, o], axis=-1) @ w_out
    return x + _rms(mix, norm_post_w), ak, av, s_new


def setup_inputs(seed: int = 0) -> dict:
    key = jax.random.key(seed)
    ks = jax.random.split(key, 13)
    nrm = jax.random.normal
    f32 = jnp.float32
    return {
        'x_prompt': nrm(ks[0], (BATCH, SEQ, D_MODEL), f32),
        'x_sample': nrm(ks[1], (DEC_BATCH, DEC_SEQ, D_MODEL), f32),
        'cache_k': nrm(ks[2], (DEPTH, DEC_BATCH, WINDOW, N_KV_HEADS, HEAD_DIM), f32),
        'cache_v': nrm(ks[3], (DEPTH, DEC_BATCH, WINDOW, N_KV_HEADS, HEAD_DIM), f32),
        'state_gla': 0.5 * nrm(ks[4], (DEPTH, DEC_BATCH, GLA_HEADS, GLA_DK, GLA_DV), f32),
        'norm_pre_w': 1.0 + 0.01 * nrm(ks[5], (DEPTH, D_MODEL), f32),
        'w_in': nrm(ks[6], (DEPTH, D_MODEL, D_IN), f32) * (D_MODEL ** -0.5),
        'attn_sinks': 0.5 * nrm(ks[7], (DEPTH, N_HEADS), f32),
        'w_gk_up': nrm(ks[8], (DEPTH, GLA_RANK, GLA_HEADS * GLA_DK), f32) * (GLA_RANK ** -0.5),
        'b_gk': 0.1 * nrm(ks[9], (DEPTH, GLA_HEADS * GLA_DK), f32),
        'gla_norm_w': 1.0 + 0.01 * nrm(ks[10], (DEPTH, GLA_DV), f32),
        'w_out': nrm(ks[11], (DEPTH, D_MIX, D_MODEL), f32) * (D_MIX ** -0.5),
        'norm_post_w': 1.0 + 0.01 * nrm(ks[12], (DEPTH, D_MODEL), f32),
    }


def reference(x_prompt, x_sample, cache_k, cache_v, state_gla, norm_pre_w, w_in, attn_sinks, w_gk_up, b_gk, gla_norm_w, w_out, norm_post_w):
    B, T_p = x_prompt.shape[:2]
    T_s = x_sample.shape[1]
    pos_p = jnp.arange(T_p)
    pos_s = PAST_LEN + jnp.arange(T_s)
    y_p, y_s = x_prompt, x_sample
    kp_l, vp_l, sp_l, ks_l, vs_l, ss_l = [], [], [], [], [], []
    for l in range(DEPTH):
        w = (norm_pre_w[l], w_in[l], attn_sinks[l], w_gk_up[l], b_gk[l], gla_norm_w[l], w_out[l], norm_post_w[l])
        s0 = jnp.zeros((B, GLA_HEADS, GLA_DK, GLA_DV), jnp.float32)
        y_p, kp, vp, sp = _layer(y_p, pos_p, _attend_prompt, s0, CHUNK, *w)
        att_s = functools.partial(_attend_sample, cache_k=cache_k[l], cache_v=cache_v[l])
        y_s, k_s, v_s, s_s = _layer(y_s, pos_s, att_s, state_gla[l], T_s, *w)
        kp_l.append(kp[:, -WINDOW:])
        vp_l.append(vp[:, -WINDOW:])
        sp_l.append(sp.astype(x_prompt.dtype))
        ks_l.append(k_s)
        vs_l.append(v_s)
        ss_l.append(s_s.astype(state_gla.dtype))
    new_k_prompt = jnp.stack(kp_l)
    new_v_prompt = jnp.stack(vp_l)
    new_state_prompt = jnp.stack(sp_l)
    new_k_sample = jnp.stack(ks_l)
    new_v_sample = jnp.stack(vs_l)
    new_state_sample = jnp.stack(ss_l)
    return (y_p, y_s, new_k_prompt, new_v_prompt, new_state_prompt, new_k_sample, new_v_sample, new_state_sample)
```

```cpp
#include <hip/hip_runtime.h>
#include <stdint.h>

typedef unsigned short bf16_t;
typedef short bf16x8 __attribute__((ext_vector_type(8)));
typedef float f32x16 __attribute__((ext_vector_type(16)));
typedef float f32x4 __attribute__((ext_vector_type(4)));
typedef unsigned u32x4 __attribute__((ext_vector_type(4)));

constexpr int D = 1024, TP = 4096, TS = 32, MP = 4 * TP, MS = 32 * TS, M = MP + MS;
constexpr int ZW = 2816, N1 = 3072, PAST = 4096;
constexpr int Z_AQ = 0, Z_AK = 512, Z_AV = 640, Z_AG = 768, Z_GQ = 1280, Z_GK = 1536, Z_GV = 1792, Z_GG = 2304;
constexpr float QSCALE = 0.125f * 1.4426950408889634f;
constexpr float LOG2E = 1.4426950408889634f;
constexpr float EPS = 1e-6f;
constexpr size_t O_YP = 0, O_YS = 16777216, O_NKP = 17825792, O_NVP = 17891328, O_NSP = 17956864, O_NKS = 18087936, O_NVS = 18219008, O_NSS = 18350080;
constexpr size_t MiB = 1u << 20;
constexpr size_t WS_W1T = 1 * MiB;
constexpr size_t WS_W2T = 8 * MiB;
constexpr size_t WS_CS = 10 * MiB;
constexpr size_t WS_XN = 12 * MiB;
constexpr size_t WS_Z = 48 * MiB;
constexpr size_t WS_LA = 144 * MiB;
constexpr size_t WS_MIX = 164 * MiB;

__device__ __forceinline__ unsigned f2bf(float f) { unsigned u = __builtin_bit_cast(unsigned, f); return (u + 0x7fffu + ((u >> 16) & 1u)) >> 16; }
__device__ __forceinline__ float bf2f(unsigned short b) { return __builtin_bit_cast(float, (unsigned)b << 16); }
__device__ __forceinline__ int crow(int reg, int h) { return (reg & 3) + 8 * (reg >> 2) + 4 * h; }
__device__ __forceinline__ float wave_sum(float v) {
#pragma unroll
    for (int o = 1; o < 64; o <<= 1) v += __shfl_xor(v, o);
    return v;
}
__device__ __forceinline__ float silu(float x) { return x / (1.f + __expf(-x)); }
__device__ __forceinline__ float log_sigmoid(float x) { return fminf(x, 0.f) - log1pf(expf(-fabsf(x))); }
__device__ __forceinline__ const float* xrow(const float* xp, const float* xs, int m) { return m < MP ? xp + (size_t)m * D : xs + (size_t)(m - MP) * D; }
__device__ __forceinline__ int row_pos(int m) { return m < MP ? (m & (TP - 1)) : PAST + ((m - MP) & (TS - 1)); }

__global__ void __launch_bounds__(256) k_xn(const float* xp, const float* xs, bf16_t* XN) {
    const int m = blockIdx.x * 4 + (threadIdx.x >> 6), lane = threadIdx.x & 63;
    const f32x4* xr = (const f32x4*)xrow(xp, xs, m) + lane;
    f32x4 v[4]; float s = 0.f;
#pragma unroll
    for (int j = 0; j < 4; ++j) { v[j] = xr[64 * j]; s += v[j].x * v[j].x + v[j].y * v[j].y + v[j].z * v[j].z + v[j].w * v[j].w; }
    const float rstd = rsqrtf(wave_sum(s) * (1.f / D) + EPS);
    unsigned long long* o8 = (unsigned long long*)(XN + (size_t)m * D) + lane;
#pragma unroll
    for (int j = 0; j < 4; ++j) {
        const unsigned lo = f2bf(v[j].x * rstd) | (f2bf(v[j].y * rstd) << 16), hi = f2bf(v[j].z * rstd) | (f2bf(v[j].w * rstd) << 16);
        o8[64 * j] = (unsigned long long)lo | ((unsigned long long)hi << 32);
    }
}
__global__ void __launch_bounds__(256) k_wt(const float* w_in, const float* w_pre, const float* w_gk_up, const float* w_out, bf16_t* W1T, bf16_t* W2T) {
    __shared__ float tile[32][33];
    const int nb = blockIdx.x, kb = blockIdx.y, tx = threadIdx.x & 31, ty = threadIdx.x >> 5;
    const bool second = nb >= N1 / 32;
    const int n0 = (second ? nb - N1 / 32 : nb) * 32, k0 = kb * 32;
    for (int i = ty; i < 32; i += 8) {
        const int k = k0 + i, n = n0 + tx; float v;
        if (second) v = w_out[(size_t)k * D + n];
        else if (n < ZW) v = w_in[(size_t)k * 2832 + n] * w_pre[k];
        else { float s = 0.f; for (int r = 0; r < 16; ++r) s += w_in[(size_t)k * 2832 + ZW + r] * w_gk_up[r * 256 + (n - ZW)]; v = s * w_pre[k]; }
        tile[i][tx] = v;
    }
    __syncthreads();
    bf16_t* dst = second ? W2T : W1T;
    for (int i = ty; i < 32; i += 8) dst[(size_t)(n0 + i) * D + k0 + tx] = (bf16_t)f2bf(tile[tx][i]);
}
__global__ void k_cs(float2* CS) {
    const int idx = blockIdx.x * blockDim.x + threadIdx.x; if (idx >= 4128 * 8) return;
    const int pos = idx >> 3, i = idx & 7;
    const float inv = powf(500000.0f, -(float)i * 0.125f);
    const float ang = (float)pos * inv;
    CS[idx] = make_float2(cosf(ang), sinf(ang));
}

__global__ void __launch_bounds__(256) k_gemm1(const bf16_t* XN, const bf16_t* W1T, const float2* CS, const float* b_gk, bf16_t* Z, float* LA, float* out) {
    const int wave = threadIdx.x >> 6, lane = threadIdx.x & 63, r = lane & 31, h = lane >> 5;
    const int n0 = blockIdx.x * 128 + wave * 32, m0 = blockIdx.y * 32;
    const bf16_t* ap = W1T + (size_t)(n0 + r) * D + 8 * h;
    const bf16_t* bp = XN + (size_t)(m0 + r) * D + 8 * h;
    f32x16 acc; for (int i = 0; i < 16; ++i) acc[i] = 0.f;
#pragma unroll 8
    for (int k0 = 0; k0 < D; k0 += 16) {
        const bf16x8 a = *(const bf16x8*)(ap + k0), b = *(const bf16x8*)(bp + k0);
        acc = __builtin_amdgcn_mfma_f32_32x32x16_bf16(a, b, acc, 0, 0, 0);
    }
    const int m = m0 + r;
    if (n0 < Z_AV) {
        if ((n0 & 63) == 0) {
            const float2* cs = CS + (size_t)row_pos(m) * 8;
#pragma unroll
            for (int j = 0; j < 4; ++j) { const float2 c = cs[j + 4 * h]; const float x1 = acc[j], x2 = acc[4 + j]; acc[j] = x1 * c.x - x2 * c.y; acc[4 + j] = x1 * c.y + x2 * c.x; }
        }
        if (n0 < Z_AK) { for (int i = 0; i < 16; ++i) acc[i] *= QSCALE; }
        else {
            float* dst = nullptr;
            if (m >= MP) dst = out + O_NKS + (size_t)(m - MP) * 128;
            else if ((m & (TP - 1)) >= TP - 128) dst = out + O_NKP + (size_t)((m >> 12) * 128 + (m & (TP - 1)) - (TP - 128)) * 128;
            if (dst) for (int i = 0; i < 16; ++i) dst[n0 - Z_AK + crow(i, h)] = acc[i];
        }
    } else if (n0 < Z_AG) {
        float* dst = nullptr;
        if (m >= MP) dst = out + O_NVS + (size_t)(m - MP) * 128;
        else if ((m & (TP - 1)) >= TP - 128) dst = out + O_NVP + (size_t)((m >> 12) * 128 + (m & (TP - 1)) - (TP - 128)) * 128;
        if (dst) for (int i = 0; i < 16; ++i) dst[n0 - Z_AV + crow(i, h)] = acc[i];
    } else if (n0 < Z_GQ || (n0 >= Z_GG && n0 < ZW)) { for (int i = 0; i < 16; ++i) acc[i] = silu(acc[i]); }
    if (n0 < ZW) { for (int i = 0; i < 16; ++i) Z[(size_t)m * ZW + n0 + crow(i, h)] = (bf16_t)f2bf(acc[i]); }
    else { for (int i = 0; i < 16; ++i) { const int c = n0 - ZW + crow(i, h); LA[(size_t)m * 256 + c] = log_sigmoid(acc[i] + b_gk[c]) * (1.f / 16.f); } }
}

__global__ void __launch_bounds__(256) k_attn(const bf16_t* Z, const float* cache_k, const float* cache_v, const float* sinks, bf16_t* MIX) {
    __shared__ __attribute__((aligned(16))) bf16_t Ks[192 * 64];
    __shared__ __attribute__((aligned(16))) bf16_t Vs[192 * 64];
    const int u = blockIdx.x, tid = threadIdx.x;
    int nkeys, qrow0, nq, kvh;
    if (u < 512) {
        const int b = u >> 7, n = (u >> 1) & 63; kvh = u & 1;
        const int c0 = n >= 2 ? n - 2 : 0; nkeys = (n - c0 + 1) * 64; qrow0 = b * TP + n * 64; nq = 64;
        const int krow0 = b * TP + c0 * 64;
        for (int p = tid; p < nkeys * 8; p += 256) { const int j = p >> 3, ch = p & 7;
            *(u32x4*)(Ks + j * 64 + ch * 8) = *(const u32x4*)(Z + (size_t)(krow0 + j) * ZW + Z_AK + kvh * 64 + ch * 8);
            *(u32x4*)(Vs + j * 64 + ch * 8) = *(const u32x4*)(Z + (size_t)(krow0 + j) * ZW + Z_AV + kvh * 64 + ch * 8); }
    } else {
        const int us = u - 512, b = us >> 1; kvh = us & 1; nkeys = 160; qrow0 = MP + b * TS; nq = 32;
        for (int p = tid; p < 128 * 64; p += 256) { const int j = p >> 6, d = p & 63;
            Ks[j * 64 + d] = (bf16_t)f2bf(cache_k[((size_t)(b * 128 + j) * 2 + kvh) * 64 + d]);
            Vs[j * 64 + d] = (bf16_t)f2bf(cache_v[((size_t)(b * 128 + j) * 2 + kvh) * 64 + d]); }
        for (int p = tid; p < 32 * 8; p += 256) { const int j = p >> 3, ch = p & 7;
            *(u32x4*)(Ks + (128 + j) * 64 + ch * 8) = *(const u32x4*)(Z + (size_t)(qrow0 + j) * ZW + Z_AK + kvh * 64 + ch * 8);
            *(u32x4*)(Vs + (128 + j) * 64 + ch * 8) = *(const u32x4*)(Z + (size_t)(qrow0 + j) * ZW + Z_AV + kvh * 64 + ch * 8); }
    }
    __syncthreads();
    const int g = tid / nq, qi = tid % nq;
    if (g >= 4) return;
    const int head = kvh * 4 + g, m = qrow0 + qi;
    float q[64], o[64];
    const bf16_t* qp = Z + (size_t)m * ZW + Z_AQ + head * 64;
#pragma unroll
    for (int d = 0; d < 64; ++d) { q[d] = bf2f(qp[d]); o[d] = 0.f; }
    float mr = -1e30f, l = 0.f;
    for (int j = 0; j < nkeys; ++j) {
        float s = 0.f;
#pragma unroll
        for (int d = 0; d < 64; ++d) s += q[d] * bf2f(Ks[j * 64 + d]);
        const float mn = fmaxf(mr, s), f = exp2f(mr - mn), p = exp2f(s - mn);
        l = l * f + p; mr = mn;
#pragma unroll
        for (int d = 0; d < 64; ++d) o[d] = o[d] * f + p * bf2f(Vs[j * 64 + d]);
    }
    const float sk = sinks[head] * LOG2E, mn = fmaxf(mr, sk), f = exp2f(mr - mn);
    l = l * f + exp2f(sk - mn);
    const float sc = f / l;
    const bf16_t* gp = Z + (size_t)m * ZW + Z_AG + head * 64;
    bf16_t* op = MIX + (size_t)m * D + head * 64;
#pragma unroll
    for (int d = 0; d < 64; ++d) op[d] = (bf16_t)f2bf(o[d] * sc * bf2f(gp[d]));
}

__global__ void __launch_bounds__(128) k_gla(const bf16_t* Z, const float* LA, const float* state_in, const float* gnw, bf16_t* MIX, float* out) {
    __shared__ __attribute__((aligned(16))) float qs[32 * 64], ks[32 * 64], as[32 * 64];
    __shared__ float os[32 * 129];
    __shared__ float rs[32];
    const int u = blockIdx.x, e = threadIdx.x;
    int row0, ntok, h; const float* s0 = nullptr; float* sout;
    if (u < 16) { const int b = u >> 2; h = u & 3; row0 = b * TP; ntok = TP; sout = out + O_NSP + (size_t)(b * 4 + h) * 64 * 128; }
    else { const int us = u - 16, b = us >> 2; h = us & 3; row0 = MP + b * TS; ntok = TS; s0 = state_in + (size_t)(b * 4 + h) * 64 * 128; sout = out + O_NSS + (size_t)(b * 4 + h) * 64 * 128; }
    float S[64];
#pragma unroll
    for (int d = 0; d < 64; ++d) S[d] = s0 ? s0[d * 128 + e] : 0.f;
    const float gw = gnw[e];
    for (int t0 = 0; t0 < ntok; t0 += 32) {
        for (int p = e; p < 32 * 64; p += 128) { const int t = p >> 6, d = p & 63; const size_t m = row0 + t0 + t;
            qs[p] = bf2f(Z[m * ZW + Z_GQ + h * 64 + d]) * 0.125f; ks[p] = bf2f(Z[m * ZW + Z_GK + h * 64 + d]); as[p] = expf(LA[m * 256 + h * 64 + d]); }
        __syncthreads();
        for (int t = 0; t < 32; ++t) {
            const float v = bf2f(Z[(size_t)(row0 + t0 + t) * ZW + Z_GV + h * 128 + e]);
            float o = 0.f;
#pragma unroll
            for (int d = 0; d < 64; ++d) { S[d] = as[t * 64 + d] * S[d] + ks[t * 64 + d] * v; o += qs[t * 64 + d] * S[d]; }
            os[t * 129 + e] = o;
        }
        __syncthreads();
        if (e < 32) { float s = 0.f; for (int c = 0; c < 128; ++c) { const float x = os[e * 129 + c]; s += x * x; } rs[e] = rsqrtf(s * (1.f / 128.f) + EPS); }
        __syncthreads();
        for (int t = 0; t < 32; ++t) { const size_t m = row0 + t0 + t;
            MIX[m * D + 512 + h * 128 + e] = (bf16_t)f2bf(os[t * 129 + e] * rs[t] * gw * bf2f(Z[m * ZW + Z_GG + h * 128 + e])); }
        __syncthreads();
    }
#pragma unroll
    for (int d = 0; d < 64; ++d) sout[d * 128 + e] = S[d];
}

__global__ void __launch_bounds__(256) k_gemm2(const bf16_t* MIX, const bf16_t* W2T, float* Y) {
    const int wave = threadIdx.x >> 6, lane = threadIdx.x & 63, r = lane & 31, h = lane >> 5;
    const int n0 = blockIdx.x * 128 + wave * 32, m0 = blockIdx.y * 32;
    const bf16_t* ap = W2T + (size_t)(n0 + r) * D + 8 * h;
    const bf16_t* bp = MIX + (size_t)(m0 + r) * D + 8 * h;
    f32x16 acc; for (int i = 0; i < 16; ++i) acc[i] = 0.f;
#pragma unroll 8
    for (int k0 = 0; k0 < D; k0 += 16) {
        const bf16x8 a = *(const bf16x8*)(ap + k0), b = *(const bf16x8*)(bp + k0);
        acc = __builtin_amdgcn_mfma_f32_32x32x16_bf16(a, b, acc, 0, 0, 0);
    }
    for (int i = 0; i < 16; ++i) Y[(size_t)(m0 + r) * D + n0 + crow(i, h)] = acc[i];
}
__global__ void __launch_bounds__(256) k_post(const float* xp, const float* xs, const float* wpost, float* Y) {
    const int m = blockIdx.x * 4 + (threadIdx.x >> 6), lane = threadIdx.x & 63;
    const f32x4* xr = (const f32x4*)xrow(xp, xs, m) + lane;
    f32x4* yr = (f32x4*)(Y + (size_t)m * D) + lane;
    const f32x4* wr = (const f32x4*)wpost + lane;
    f32x4 v[4]; float s = 0.f;
#pragma unroll
    for (int j = 0; j < 4; ++j) { v[j] = yr[64 * j]; s += v[j].x * v[j].x + v[j].y * v[j].y + v[j].z * v[j].z + v[j].w * v[j].w; }
    const float rstd = rsqrtf(wave_sum(s) * (1.f / D) + EPS);
#pragma unroll
    for (int j = 0; j < 4; ++j) yr[64 * j] = xr[64 * j] + v[j] * rstd * wr[64 * j];
}

extern "C" void kernel_launch(void* const* d_in, const int* in_sizes, int n_in, void* d_out, int out_size, void* d_ws, size_t ws_size, hipStream_t stream) {
    const float* xp = (const float*)d_in[0]; const float* xs = (const float*)d_in[1];
    const float* cache_k = (const float*)d_in[2]; const float* cache_v = (const float*)d_in[3]; const float* state_gla = (const float*)d_in[4];
    const float* w_pre = (const float*)d_in[5]; const float* w_in = (const float*)d_in[6]; const float* sinks = (const float*)d_in[7];
    const float* w_gk_up = (const float*)d_in[8]; const float* b_gk = (const float*)d_in[9]; const float* gnw = (const float*)d_in[10];
    const float* w_out = (const float*)d_in[11]; const float* w_post = (const float*)d_in[12];
    float* out = (float*)d_out; unsigned char* ws = (unsigned char*)d_ws;
    bf16_t* W1T = (bf16_t*)(ws + WS_W1T); bf16_t* W2T = (bf16_t*)(ws + WS_W2T); float2* CS = (float2*)(ws + WS_CS);
    bf16_t* XN = (bf16_t*)(ws + WS_XN); bf16_t* Z = (bf16_t*)(ws + WS_Z); float* LA = (float*)(ws + WS_LA); bf16_t* MIX = (bf16_t*)(ws + WS_MIX);
    k_xn<<<M / 4, 256, 0, stream>>>(xp, xs, XN);
    k_wt<<<dim3(N1 / 32 + D / 32, D / 32), 256, 0, stream>>>(w_in, w_pre, w_gk_up, w_out, W1T, W2T);
    k_cs<<<(4128 * 8 + 255) / 256, 256, 0, stream>>>(CS);
    k_gemm1<<<dim3(N1 / 128, M / 32), 256, 0, stream>>>(XN, W1T, CS, b_gk, Z, LA, out);
    k_attn<<<512 + 64, 256, 0, stream>>>(Z, cache_k, cache_v, sinks, MIX);
    k_gla<<<16 + 128, 128, 0, stream>>>(Z, LA, state_gla, gnw, MIX, out);
    k_gemm2<<<dim3(D / 128, M / 32), 256, 0, stream>>>(MIX, W2T, out);
    k_post<<<M / 4, 256, 0, stream>>>(xp, xs, w_post, out);
}
```
